# Optimizing an MI355X kernel written in HIP

```python
import math
import jax, jax.numpy as jnp
from jax import lax
import numpy as np

D_MODEL = 2048
BATCH = 4
SEQ = 4096
DEPTH = 1

CHUNK = 64
N_META = 16
Q_BLOCK = 128
ROPE_THETA = 10000.0
LN_EPS = 1e-5
ATT_HALF_DIM = 64
N_ATT_HEADS = D_MODEL // (4 * ATT_HALF_DIM)
ATT_QK_WIDTH = N_ATT_HEADS * 2 * ATT_HALF_DIM
ATT_V_WIDTH = N_ATT_HEADS * 2 * ATT_HALF_DIM
CONV_DIM = D_MODEL // 2
CONV_WIDTH = 3
IN_COLS = 2 * ATT_QK_WIDTH + ATT_V_WIDTH + 3 * CONV_DIM + 2 * D_MODEL
N_EXPERTS = 64
TOP_K = 8
N_GROUPS = 8
TOPK_GROUPS = 4
D_EXPERT = D_MODEL // 4
ROUTED_SCALE = 2.5
EXPERT_BLOCK = 128
DEEPNORM_ALPHA = (2 * DEPTH) ** 0.25
DEEPNORM_BETA = (8 * DEPTH) ** -0.25

kernel_name = "chunk_causal_diffattn_shortconv_moe_hybrid"


def _layer_norm(x, g, b):
    xf = x.astype(jnp.float32)
    mu = jnp.mean(xf, axis=-1, keepdims=True)
    var = jnp.mean(jnp.square(xf - mu), axis=-1, keepdims=True)
    return ((xf - mu) * lax.rsqrt(var + LN_EPS) * g.astype(jnp.float32) + b.astype(jnp.float32)).astype(x.dtype)


def _rms_norm(x, g):
    xf = x.astype(jnp.float32)
    return (xf * lax.rsqrt(jnp.mean(xf * xf, axis=-1, keepdims=True) + LN_EPS) * g.astype(jnp.float32)).astype(x.dtype)


def _rope(x, pos):
    half = x.shape[-1] // 2
    inv_freq = ROPE_THETA ** (-jnp.arange(half, dtype=jnp.float32) / half)
    ang = pos.astype(jnp.float32)[:, None] * inv_freq[None, :]
    cos = jnp.cos(ang)[None, :, None, None, :]
    sin = jnp.sin(ang)[None, :, None, None, :]
    x1 = x[..., :half].astype(jnp.float32)
    x2 = x[..., half:].astype(jnp.float32)
    return jnp.concatenate([x1 * cos - x2 * sin, x2 * cos + x1 * sin], axis=-1).astype(x.dtype)


def _diff_attn_block(q, k, v, q_cid, k_cid, lam):
    s = jnp.einsum('bqhmd,bkhmd->bhmqk', q, k, preferred_element_type=jnp.float32) * (ATT_HALF_DIM ** -0.5)
    visible = k_cid[None, :] <= q_cid[:, None]
    p = jax.nn.softmax(jnp.where(visible, s, -jnp.inf), axis=-1)
    a = p[:, :, 0] - lam * p[:, :, 1]
    return jnp.einsum('bhqk,bkhe->bqhe', a.astype(v.dtype), v)


def _mixer(h, q0, lam_init, w_in, lambda_q1, lambda_k1, lambda_q2, lambda_k2, subln_g,
           w_conv, w_proj_attn, w_proj_conv, w_out):
    B, L, _ = h.shape
    u = h @ w_in
    splits = [int(c) for c in np.cumsum([ATT_QK_WIDTH, ATT_QK_WIDTH, ATT_V_WIDTH,
                                          CONV_DIM, CONV_DIM, CONV_DIM, D_MODEL])]
    q, k, v, cx, cc, cb, ga, gc = jnp.split(u, splits, axis=-1)

    pos = jnp.arange(L, dtype=jnp.int32)
    cid = jnp.where(pos < N_META, -1, (pos - N_META) // CHUNK)

    q = _rope(q.reshape(B, L, N_ATT_HEADS, 2, ATT_HALF_DIM), pos)
    k = _rope(k.reshape(B, L, N_ATT_HEADS, 2, ATT_HALF_DIM), pos)
    v = v.reshape(B, L, N_ATT_HEADS, 2 * ATT_HALF_DIM)
    f32 = jnp.float32
    lam = (jnp.exp(jnp.sum(lambda_q1.astype(f32) * lambda_k1.astype(f32)))
           - jnp.exp(jnp.sum(lambda_q2.astype(f32) * lambda_k2.astype(f32))) + lam_init)
    blocks = [(0, N_META)] if q0 == 0 else []
    blocks = blocks + [(s, s + Q_BLOCK) for s in range(N_META, L, Q_BLOCK)]
    outs = [_diff_attn_block(q[:, s:e], k[:, :e], v[:, :e], cid[s:e], cid[:e], lam) for s, e in blocks]
    o = jnp.concatenate(outs, axis=1)
    o = (_rms_norm(o, subln_g) * (1.0 - lam_init)).reshape(B, L - q0, ATT_V_WIDTH)

    z = cc * cx
    y = lax.conv_general_dilated(z, w_conv[:, None, :].astype(z.dtype), window_strides=(1,),
                                 padding=[(CONV_WIDTH - 1, 0)],
                                 dimension_numbers=('NWC', 'WIO', 'NWC'),
                                 feature_group_count=CONV_DIM)
    y = cb[:, q0:] * y[:, q0:]

    merged = (jax.nn.sigmoid(ga[:, q0:]) * (o @ w_proj_attn)
              + jax.nn.sigmoid(gc[:, q0:]) * (y @ w_proj_conv))
    return merged @ w_out


def _routed_experts(xf, eidx, ew, w_exp_gate, w_exp_up, w_exp_down):
    N, D = xf.shape
    A = N * TOP_K
    flat_e = eidx.reshape(A)
    flat_tok = jnp.arange(A, dtype=jnp.int32) // TOP_K
    flat_w = ew.reshape(A)
    order = jnp.argsort(flat_e)
    e_sorted = flat_e[order]
    counts = jnp.bincount(flat_e, length=N_EXPERTS)
    start = jnp.cumsum(counts) - counts
    padded = (counts + EXPERT_BLOCK - 1) // EXPERT_BLOCK * EXPERT_BLOCK
    pad_end = jnp.cumsum(padded)
    pad_start = pad_end - padded
    dest = pad_start[e_sorted] + jnp.arange(A, dtype=jnp.int32) - start[e_sorted]
    n_blocks = -(-A // EXPERT_BLOCK) + N_EXPERTS
    P = n_blocks * EXPERT_BLOCK
    row_tok = jnp.full((P,), N, jnp.int32).at[dest].set(flat_tok[order])
    row_w = jnp.zeros((P,), xf.dtype).at[dest].set(flat_w[order].astype(xf.dtype))
    block_e = jnp.minimum(jnp.searchsorted(pad_end, jnp.arange(n_blocks, dtype=jnp.int32) * EXPERT_BLOCK,
                                           side='right'), N_EXPERTS - 1)
    x_pad = jnp.concatenate([xf, jnp.zeros((1, D), xf.dtype)], axis=0)

    def block_fn(args):
        e, toks, wts = args
        xb = x_pad[toks]
        hb = jax.nn.silu(xb @ w_exp_gate[e]) * (xb @ w_exp_up[e])
        return (hb @ w_exp_down[e]) * wts[:, None]

    yb = lax.map(block_fn, (block_e, row_tok.reshape(n_blocks, EXPERT_BLOCK),
                            row_w.reshape(n_blocks, EXPERT_BLOCK)))
    return jax.ops.segment_sum(yb.reshape(P, D), row_tok, num_segments=N + 1)[:N]


def _moe(h, w_router, router_bias, w_exp_gate, w_exp_up, w_exp_down, w_sh_gate, w_sh_up, w_sh_down):
    B, T, D = h.shape
    xf = h.reshape(B * T, D)
    N = B * T
    logits = xf.astype(jnp.float32) @ w_router.astype(jnp.float32)
    s = jax.nn.sigmoid(logits)
    sel = s + router_bias.astype(jnp.float32)
    per_group = N_EXPERTS // N_GROUPS
    gscore = lax.top_k(sel.reshape(N, N_GROUPS, per_group), 2)[0].sum(-1)
    _, gidx = lax.top_k(gscore, TOPK_GROUPS)
    gmask = jax.nn.one_hot(gidx, N_GROUPS, dtype=jnp.float32).sum(-2) > 0
    sel = jnp.where(jnp.repeat(gmask, per_group, axis=-1), sel, -jnp.inf)
    _, eidx = lax.top_k(sel, TOP_K)
    ew = jnp.take_along_axis(s, eidx, axis=-1)
    ew = ew / jnp.sum(ew, axis=-1, keepdims=True) * ROUTED_SCALE
    shared = (jax.nn.silu(xf @ w_sh_gate) * (xf @ w_sh_up)) @ w_sh_down
    routed = _routed_experts(xf, eidx, ew, w_exp_gate, w_exp_up, w_exp_down)
    return (shared + routed).reshape(B, T, D)


def setup_inputs(seed: int = 0) -> dict:
    key = jax.random.key(seed)
    ks = jax.random.split(key, 32)

    def nrm(k, shape, scale):
        return jax.random.normal(k, shape, jnp.float32) * scale

    D, L_ = D_MODEL, DEPTH
    beta = DEEPNORM_BETA
    col_scale = jnp.concatenate([
        jnp.ones((2 * ATT_QK_WIDTH,), jnp.float32),
        jnp.full((ATT_V_WIDTH + CONV_DIM,), beta, jnp.float32),
        jnp.ones((2 * CONV_DIM + 2 * D_MODEL,), jnp.float32)])
    return {
        "x": nrm(ks[0], (BATCH, SEQ, D), 1.0),
        "meta_tokens": nrm(ks[1], (N_META, D), 1.0),
        "ln0_g": 1.0 + nrm(ks[2], (D,), 0.02),
        "ln0_b": nrm(ks[3], (D,), 0.02),
        "w_in": nrm(ks[4], (L_, D, IN_COLS), D ** -0.5) * col_scale,
        "lambda_q1": nrm(ks[5], (L_, ATT_HALF_DIM), 0.1),
        "lambda_k1": nrm(ks[6], (L_, ATT_HALF_DIM), 0.1),
        "lambda_q2": nrm(ks[7], (L_, ATT_HALF_DIM), 0.1),
        "lambda_k2": nrm(ks[8], (L_, ATT_HALF_DIM), 0.1),
        "subln_g": 1.0 + nrm(ks[9], (L_, 2 * ATT_HALF_DIM), 0.02),
        "w_conv": nrm(ks[10], (L_, CONV_WIDTH, CONV_DIM), CONV_WIDTH ** -0.5),
        "w_proj_attn": nrm(ks[11], (L_, ATT_V_WIDTH, D), ATT_V_WIDTH ** -0.5 * beta),
        "w_proj_conv": nrm(ks[12], (L_, CONV_DIM, D), CONV_DIM ** -0.5 * beta),
        "w_out": nrm(ks[13], (L_, D, D), D ** -0.5 * beta),
        "ln1_g": 1.0 + nrm(ks[14], (L_, D), 0.02),
        "ln1_b": nrm(ks[15], (L_, D), 0.02),
        "w_router": nrm(ks[16], (L_, D, N_EXPERTS), D ** -0.5),
        "router_bias": nrm(ks[17], (L_, N_EXPERTS), 0.01),
        "w_exp_gate": nrm(ks[18], (L_, N_EXPERTS, D, D_EXPERT), D ** -0.5 * beta),
        "w_exp_up": nrm(ks[19], (L_, N_EXPERTS, D, D_EXPERT), D ** -0.5 * beta),
        "w_exp_down": nrm(ks[20], (L_, N_EXPERTS, D_EXPERT, D), D_EXPERT ** -0.5 * beta),
        "w_sh_gate": nrm(ks[21], (L_, D, D_EXPERT), D ** -0.5 * beta),
        "w_sh_up": nrm(ks[22], (L_, D, D_EXPERT), D ** -0.5 * beta),
        "w_sh_down": nrm(ks[23], (L_, D_EXPERT, D), D_EXPERT ** -0.5 * beta),
        "ln2_g": 1.0 + nrm(ks[24], (L_, D), 0.02),
        "ln2_b": nrm(ks[25], (L_, D), 0.02),
    }


def reference(x, meta_tokens, ln0_g, ln0_b, w_in, lambda_q1, lambda_k1, lambda_q2, lambda_k2,
              subln_g, w_conv, w_proj_attn, w_proj_conv, w_out, ln1_g, ln1_b, w_router,
              router_bias, w_exp_gate, w_exp_up, w_exp_down, w_sh_gate, w_sh_up, w_sh_down,
              ln2_g, ln2_b):
    B = x.shape[0]
    meta = jnp.broadcast_to(meta_tokens[None].astype(x.dtype), (B, N_META, D_MODEL))
    h = _layer_norm(jnp.concatenate([meta, x], axis=1), ln0_g, ln0_b)
    for l in range(DEPTH):
        q0 = N_META if l == DEPTH - 1 else 0
        lam_init = 0.8 - 0.6 * math.exp(-0.3 * l)
        m = _mixer(h, q0, lam_init, w_in[l], lambda_q1[l], lambda_k1[l], lambda_q2[l], lambda_k2[l],
                   subln_g[l], w_conv[l], w_proj_attn[l], w_proj_conv[l], w_out[l])
        h1 = _layer_norm(DEEPNORM_ALPHA * h[:, q0:] + m, ln1_g[l], ln1_b[l])
        f = _moe(h1, w_router[l], router_bias[l], w_exp_gate[l], w_exp_up[l], w_exp_down[l],
                 w_sh_gate[l], w_sh_up[l], w_sh_down[l])
        h = _layer_norm(DEEPNORM_ALPHA * h1 + f, ln2_g[l], ln2_b[l])
    return h
```

```cpp
#include <hip/hip_runtime.h>
#include <hip/hip_cooperative_groups.h>
#include <cstdio>
#include <cstdint>
namespace cg = cooperative_groups;

#define LAS __attribute__((address_space(3)))
typedef unsigned short bf16_t;
typedef short bf16x8 __attribute__((ext_vector_type(8)));
typedef short s16x4 __attribute__((ext_vector_type(4)));
typedef float f32x4 __attribute__((ext_vector_type(4)));
typedef float f32x16 __attribute__((ext_vector_type(16)));
typedef unsigned u32x4 __attribute__((ext_vector_type(4)));
typedef unsigned u32x2 __attribute__((ext_vector_type(2)));

constexpr int NB = 4, SEQ = 4096, DM = 2048, NTOK = NB * SEQ, NMETA = 16, NH = 8;
constexpr int QKW = 1024, INC = 10240, NE = 64, TOPK = 8, DE = 512;
constexpr float LN_EPS = 1e-5f, ALPHA = 1.189207115002721f, LAM_INIT = 0.2f, ROUTED_SCALE = 2.5f;
constexpr int NPOS = NMETA + SEQ;

constexpr size_t MiB = 1u << 20, KiB = 1u << 10;
constexpr size_t WS_CTL = 0;
constexpr size_t CTL_COUNTS = 0;
constexpr size_t WS_KMETA = 64 * KiB;
constexpr size_t WS_VMETA = 192 * KiB;
constexpr size_t CTL_ZERO_BYTES = 320 * KiB;
constexpr size_t WS_SCAL = 384 * KiB;
constexpr size_t WS_ZMETA = 400 * KiB;
constexpr size_t WS_ROPE = 1 * MiB;
constexpr size_t WS_UMETA = 3 * MiB;
constexpr size_t WS_STATS0 = 4 * MiB;
constexpr size_t WS_WRH = 4 * MiB + 512 * KiB;
constexpr size_t WS_WRL = 4 * MiB + 768 * KiB;
constexpr size_t WS_EW = 5 * MiB;
constexpr size_t WS_LIST = 6 * MiB;
constexpr size_t WS_HBUF = 16 * MiB;
constexpr size_t WS_O = 16 * MiB;
constexpr size_t WS_Y = 48 * MiB;
constexpr size_t WS_SGA = 80 * MiB;
constexpr size_t WS_MERGED = 144 * MiB;
constexpr size_t WS_WGU = 208 * MiB;
constexpr size_t WS_WINT = 468 * MiB;
constexpr size_t WS_WPA = 508 * MiB;
constexpr size_t WS_WPC = 512 * MiB;
constexpr size_t WS_WOUT = 516 * MiB;
constexpr size_t WS_YK = 16 * MiB;
constexpr size_t WS_WD = 592 * MiB;
constexpr size_t WS_H1 = 722 * MiB;
constexpr size_t WS_SGC = 722 * MiB;
constexpr size_t WS_HB = 786 * MiB;
constexpr size_t WS_HBSH = 930 * MiB;
constexpr size_t WS_Q = 786 * MiB, WS_K = 818 * MiB, WS_V = 850 * MiB, WS_Z = 882 * MiB, WS_CB = 914 * MiB;
constexpr size_t WS_END = 946 * MiB;

constexpr int RING_BYTES = 131072;
constexpr int LDSX_OFF = RING_BYTES;
constexpr int LDS_BYTES = 147456;

__device__ const float INV_FREQ[32] = {
  1.000000000e+00f, 7.498942614e-01f, 5.623413324e-01f, 4.216965139e-01f, 3.162277639e-01f, 2.371373773e-01f, 1.778279394e-01f, 1.333521307e-01f,
  1.000000015e-01f, 7.498941571e-02f, 5.623413250e-02f, 4.216965288e-02f, 3.162277490e-02f, 2.371373773e-02f, 1.778279431e-02f, 1.333521493e-02f,
  9.999999776e-03f, 7.498941850e-03f, 5.623413250e-03f, 4.216964822e-03f, 3.162277630e-03f, 2.371373586e-03f, 1.778279431e-03f, 1.333521446e-03f,
  1.000000047e-03f, 7.498942432e-04f, 5.623413017e-04f, 4.216965172e-04f, 3.162277571e-04f, 2.371373703e-04f, 1.778279402e-04f, 1.333521504e-04f};

#define LDS_WAIT() asm volatile("s_waitcnt lgkmcnt(0)" ::: "memory")
#define VM_WAIT() asm volatile("s_waitcnt vmcnt(0)" ::: "memory")
__device__ __forceinline__ unsigned cvt_pk_bf16(float lo, float hi) { unsigned r; asm volatile("v_cvt_pk_bf16_f32 %0, %1, %2" : "=v"(r) : "v"(lo), "v"(hi)); return r; }
__device__ __forceinline__ unsigned f2bf(float f) { unsigned u = __builtin_bit_cast(unsigned, f); return (u + 0x7fffu + ((u >> 16) & 1u)) >> 16; }
__device__ __forceinline__ float bf2f(unsigned b) { return __builtin_bit_cast(float, b << 16); }
__device__ __forceinline__ float bflo(unsigned w) { return __builtin_bit_cast(float, w << 16); }
__device__ __forceinline__ float bfhi(unsigned w) { return __builtin_bit_cast(float, w & 0xffff0000u); }
__device__ __forceinline__ float wave_sum(float v) {
#pragma unroll
  for (int o = 1; o < 64; o <<= 1) v += __shfl_xor(v, o);
  return v;
}
__device__ __forceinline__ float fast_sigmoid(float x) { return __builtin_amdgcn_rcpf(1.0f + __builtin_amdgcn_exp2f(-1.4426950408889634f * x)); }

struct Params { const float* in[26]; float* out; unsigned char* ws; int ph_lo, ph_hi; };
enum { I_X = 0, I_META, I_LN0G, I_LN0B, I_WIN, I_LQ1, I_LK1, I_LQ2, I_LK2, I_SUBG, I_WCONV, I_WPA, I_WPC, I_WOUT, I_LN1G, I_LN1B, I_WR, I_RB, I_WEG, I_WEU, I_WED, I_WSG, I_WSU, I_WSD, I_LN2G, I_LN2B };

namespace pg8 {
constexpr int BM = 256, BK = 64, HALF = 128, HTB = HALF * BK * 2, NXCD = 8, WGM = 8;
__device__ __forceinline__ int lds_byte(int r, int c) { const int st = (r >> 4) * 2 + (c >> 5), rr = r & 15, cc = c & 31, ob = rr * 64 + cc * 2; return st * 1024 + (ob ^ (((ob >> 9) & 1) << 5)); }
__device__ __forceinline__ void stage_rc(int b, int& R, int& C) { const int st = b / 1024, sb = b % 1024, swz = sb ^ (((sb >> 9) & 1) << 5); R = (st >> 1) * 16 + swz / 64; C = (st & 1) * 32 + (swz % 64) / 2; }
__device__ __forceinline__ int perm32(int rho) { const int n = rho >> 4, i = rho & 15; return 8 * (i >> 2) + 4 * n + (i & 3); }

struct Unit { const char* A; const char* B; int pm, pn, e, seg, row0, cnt; };

__device__ __forceinline__ void order_map(int L, int nM, int nN, int& pm, int& pn) {
  const int nwg = nM * nN; int wgid = L;
  { const int q = nwg / NXCD, r = nwg % NXCD, xcd = wgid % NXCD, off = wgid / NXCD; wgid = (xcd < r ? xcd * (q + 1) : r * (q + 1) + (xcd - r) * q) + off; }
  const int nig = WGM * nN, gid = wgid / nig, fm = gid * WGM, gsz = (nM - fm) < WGM ? (nM - fm) : WGM;
  pm = fm + ((wgid % nig) % gsz); pn = (wgid % nig) / gsz;
}

template <class Epi, class Sched>
__device__ __forceinline__ void gemm_phase(LAS unsigned char* lds, const int K, const Sched& S, const Epi& E) {
  const int tid = threadIdx.x, wid = __builtin_amdgcn_readfirstlane(tid >> 6), lane = tid & 63, wr = wid >> 2, wc = wid & 3, fr = lane & 15, fq = lane >> 4;
  const int nt = K / BK;
  int R[2], C[2]; unsigned voffB[2];
#pragma unroll
  for (int i = 0; i < 2; ++i) { stage_rc(tid * 16 + i * 8192, R[i], C[i]); const int Rb = (R[i] & ~31) + perm32(R[i] & 31); voffB[i] = (unsigned)(Rb * K + C[i]) * 2u; }
  const size_t kstep = (size_t)(BK * 2);
  const size_t hstepB = (size_t)HALF * K * 2;
  const unsigned ldsw = (unsigned)wid * 1024u;
  const int aoff = lds_byte(wr * 64 + fr, fq * 8), boff = lds_byte(wc * 32 + fr, fq * 8);
#define PG8_SA(b, h) (((b) * 2 + (h)) * HTB)
#define PG8_SB(b, h) ((4 + (b) * 2 + (h)) * HTB)
#define PG8_STAGEB(bufoff, gbase) do { _Pragma("unroll") for (int _i = 0; _i < 2; ++_i) \
    __builtin_amdgcn_global_load_lds((const unsigned*)((const char*)(gbase) + voffB[_i]), (LAS unsigned*)(lds + (bufoff) + ldsw + _i * 8192), 16, 0, 0); } while (0)
#define PG8_STAGEA(bufoff, gbase, o0, o1) do { \
    __builtin_amdgcn_global_load_lds((const unsigned*)((const char*)(gbase) + (o0)), (LAS unsigned*)(lds + (bufoff) + ldsw), 16, 0, 0); \
    __builtin_amdgcn_global_load_lds((const unsigned*)((const char*)(gbase) + (o1)), (LAS unsigned*)(lds + (bufoff) + ldsw + 8192), 16, 0, 0); } while (0)
#define PG8_LDA(dst, b, h) do { _Pragma("unroll") for (int m = 0; m < 4; ++m) _Pragma("unroll") for (int k = 0; k < 2; ++k) dst[m][k] = *(const LAS bf16x8*)(lds + PG8_SA(b, h) + aoff + m * 2048 + k * 1024); } while (0)
#define PG8_LDB(dst, b, h) do { _Pragma("unroll") for (int n = 0; n < 2; ++n) _Pragma("unroll") for (int k = 0; k < 2; ++k) dst[n][k] = *(const LAS bf16x8*)(lds + PG8_SB(b, h) + boff + n * 2048 + k * 1024); } while (0)
#define PG8_MMA(ai, bj, At, Bt) do { __builtin_amdgcn_s_setprio(1); _Pragma("unroll") for (int m = 0; m < 4; ++m) _Pragma("unroll") for (int n = 0; n < 2; ++n) _Pragma("unroll") for (int k = 0; k < 2; ++k) \
    acc[ai][bj][m][n] = __builtin_amdgcn_mfma_f32_16x16x32_bf16(Bt[n][k], At[m][k], acc[ai][bj][m][n], 0, 0, 0); __builtin_amdgcn_s_setprio(0); } while (0)
#define PG8_WAIT_V(n) asm volatile("s_waitcnt vmcnt(" #n ")" ::: "memory")
#define PG8_WAIT_L(n) asm volatile("s_waitcnt lgkmcnt(" #n ")" ::: "memory")
#define PG8_BAR __builtin_amdgcn_s_barrier()
#define PG8_SCHED __builtin_amdgcn_sched_barrier(0)
  Unit cur, nxt; int ui = 0;
  if (!S.next(0, cur)) return;
  unsigned oc00, oc01, oc10, oc11, on00, on01, on10, on11;
  S.offsets(cur, R, C, oc00, oc01, oc10, oc11);
  f32x4 acc[2][2][4][2];
#pragma unroll
  for (int a = 0; a < 2; ++a)
#pragma unroll
    for (int b = 0; b < 2; ++b)
#pragma unroll
      for (int m = 0; m < 4; ++m)
#pragma unroll
        for (int n = 0; n < 2; ++n) acc[a][b][m][n] = (f32x4){0.f, 0.f, 0.f, 0.f};
  bf16x8 At[4][2], B0[2][2], B1[2][2];
  const char* cA = cur.A; const char* cB = cur.B;
  PG8_STAGEB(PG8_SB(0, 0), cB); PG8_STAGEB(PG8_SB(0, 1), cB + hstepB); PG8_STAGEA(PG8_SA(0, 0), cA, oc00, oc01); PG8_STAGEA(PG8_SA(0, 1), cA, oc10, oc11);
  if (wr == 1) PG8_BAR;
  PG8_WAIT_V(2); PG8_BAR;
  PG8_STAGEB(PG8_SB(1, 0), cB + kstep); PG8_STAGEA(PG8_SA(1, 0), cA + kstep, oc00, oc01); PG8_STAGEB(PG8_SB(1, 1), cB + hstepB + kstep);
  PG8_WAIT_V(6); PG8_BAR;
  for (;;) {
    const bool has_next = S.next(ui + 1, nxt);
    const char* nA = has_next ? nxt.A : cA; const char* nB = has_next ? nxt.B : cB;
    if (has_next) S.offsets(nxt, R, C, on00, on01, on10, on11); else { on00 = oc00; on01 = oc01; on10 = oc10; on11 = oc11; }
    for (int t = 0; t < nt; t += 2) {
      const bool last = (t == nt - 2);
      const char* a1 = cA + (size_t)(t + 1) * kstep;
      const char* a2 = last ? nA : cA + (size_t)(t + 2) * kstep; const char* b2 = last ? nB : cB + (size_t)(t + 2) * kstep;
      const char* a3 = a2 + kstep; const char* b3 = b2 + kstep;
      const unsigned p00 = last ? on00 : oc00, p01 = last ? on01 : oc01, p10 = last ? on10 : oc10, p11 = last ? on11 : oc11;
      PG8_LDB(B0, 0, 0); PG8_LDB(B1, 0, 1); PG8_SCHED; PG8_LDA(At, 0, 0); PG8_STAGEA(PG8_SA(1, 1), a1, oc10, oc11);
      PG8_WAIT_V(8); PG8_WAIT_L(0); PG8_BAR; PG8_MMA(0, 0, At, B0); PG8_MMA(0, 1, At, B1); PG8_BAR; PG8_SCHED;
      PG8_LDA(At, 0, 1); PG8_STAGEB(PG8_SB(0, 0), b2); PG8_STAGEB(PG8_SB(0, 1), b2 + hstepB); PG8_STAGEA(PG8_SA(0, 0), a2, p00, p01);
      PG8_WAIT_V(8); PG8_WAIT_L(0); PG8_BAR; PG8_MMA(1, 0, At, B0); PG8_MMA(1, 1, At, B1); PG8_BAR; PG8_SCHED;
      PG8_LDB(B0, 1, 0); PG8_LDB(B1, 1, 1); PG8_SCHED; PG8_LDA(At, 1, 0); PG8_STAGEA(PG8_SA(0, 1), a2, p10, p11);
      PG8_WAIT_V(8); PG8_WAIT_L(0); PG8_BAR; PG8_MMA(0, 0, At, B0); PG8_MMA(0, 1, At, B1); PG8_BAR; PG8_SCHED;
      PG8_LDA(At, 1, 1); PG8_STAGEB(PG8_SB(1, 0), b3); PG8_STAGEB(PG8_SB(1, 1), b3 + hstepB); PG8_STAGEA(PG8_SA(1, 0), a3, p00, p01);
      PG8_WAIT_V(8); PG8_WAIT_L(0); PG8_BAR; PG8_MMA(1, 0, At, B0); PG8_MMA(1, 1, At, B1); PG8_BAR; PG8_SCHED;
    }
    if (wr == 0) PG8_BAR;
    E(acc, cur, wr, wc, fr, fq);
    if (!has_next) break;
    if (!E.carry(cur)) {
#pragma unroll
      for (int a = 0; a < 2; ++a)
#pragma unroll
        for (int b = 0; b < 2; ++b)
#pragma unroll
          for (int m = 0; m < 4; ++m)
#pragma unroll
            for (int n = 0; n < 2; ++n) acc[a][b][m][n] = (f32x4){0.f, 0.f, 0.f, 0.f};
    }
    cur = nxt; cA = nA; cB = nB; oc00 = on00; oc01 = on01; oc10 = on10; oc11 = on11; ++ui;
    if (wr == 1) PG8_BAR;
  }
  PG8_WAIT_V(0);
  PG8_BAR;
#undef PG8_SA
#undef PG8_SB
#undef PG8_STAGEA
#undef PG8_STAGEB
#undef PG8_LDA
#undef PG8_LDB
#undef PG8_MMA
#undef PG8_WAIT_V
#undef PG8_WAIT_L
#undef PG8_BAR
#undef PG8_SCHED
}
}

using pg8::Unit;

struct OffPlain { int K;
  __device__ __forceinline__ void operator()(const int (&R)[2], const int (&C)[2], unsigned& o00, unsigned& o01, unsigned& o10, unsigned& o11) const {
    o00 = (unsigned)(R[0] * K + C[0]) * 2u; o01 = (unsigned)(R[1] * K + C[1]) * 2u; o10 = o00 + (unsigned)(128 * K * 2); o11 = o01 + (unsigned)(128 * K * 2); } };

struct SchedP1 { int G, c; const char* A; const char* B;
  __device__ __forceinline__ bool next(int i, Unit& u) const { const int L = i * G + c; if (L >= 64 * 40) return false; pg8::order_map(L, 64, 40, u.pm, u.pn);
    u.A = A + (size_t)u.pm * 256 * DM * 2; u.B = B + (size_t)u.pn * 256 * DM * 2; u.e = 0; u.seg = 0; u.row0 = 0; u.cnt = 0; return true; }
  __device__ __forceinline__ void offsets(const Unit&, const int (&R)[2], const int (&C)[2], unsigned& o00, unsigned& o01, unsigned& o10, unsigned& o11) const { OffPlain{DM}(R, C, o00, o01, o10, o11); } };
struct EpiP1 { unsigned char* ws;
  __device__ __forceinline__ bool carry(const Unit&) const { return false; }
  __device__ __forceinline__ void operator()(const f32x4 (&acc)[2][2][4][2], const Unit& u, int wr, int wc, int fr, int fq) const {
    const int row0 = u.pm * 256 + wr * 64 + fr, c8 = wc * 32 + fq * 8, pn = u.pn;
    if (pn < 8) {
      bf16_t* dst = (bf16_t*)(ws + (pn < 4 ? WS_Q : WS_K)); const int colb = (pn & 3) * 256 + wc * 64 + fq * 8; const float* rope = (const float*)(ws + WS_ROPE);
#pragma unroll
      for (int ai = 0; ai < 2; ++ai)
#pragma unroll
        for (int m = 0; m < 4; ++m) { const int row = row0 + ai * 128 + m * 16; const int pos = NMETA + (row & (SEQ - 1));
          const float* cs = rope + (size_t)pos * 32 + fq * 8; const float* sn = cs + (size_t)NPOS * 32;
          const f32x4 c0 = *(const f32x4*)cs, c1 = *(const f32x4*)(cs + 4), s0 = *(const f32x4*)sn, s1 = *(const f32x4*)(sn + 4);
          const f32x4 x10 = acc[ai][0][m][0], x11 = acc[ai][0][m][1], x20 = acc[ai][1][m][0], x21 = acc[ai][1][m][1];
          const f32x4 a0 = x10 * c0 - x20 * s0, a1 = x11 * c1 - x21 * s1, b0 = x20 * c0 + x10 * s0, b1 = x21 * c1 + x11 * s1;
          u32x4 w1, w2; w1.x = cvt_pk_bf16(a0[0], a0[1]); w1.y = cvt_pk_bf16(a0[2], a0[3]); w1.z = cvt_pk_bf16(a1[0], a1[1]); w1.w = cvt_pk_bf16(a1[2], a1[3]);
          w2.x = cvt_pk_bf16(b0[0], b0[1]); w2.y = cvt_pk_bf16(b0[2], b0[3]); w2.z = cvt_pk_bf16(b1[0], b1[1]); w2.w = cvt_pk_bf16(b1[2], b1[3]);
          bf16_t* rp = dst + (size_t)row * QKW + colb; *(u32x4*)rp = w1; *(u32x4*)(rp + 32) = w2; }
    } else if (pn >= 12 && pn < 20) {
      const int colb = (pn - 12) * 128 + c8;
#pragma unroll
      for (int ai = 0; ai < 2; ++ai)
#pragma unroll
        for (int m = 0; m < 4; ++m) { const int row = row0 + ai * 128 + m * 16;
          const f32x4 a0 = acc[ai][0][m][0] * acc[ai][1][m][0], a1 = acc[ai][0][m][1] * acc[ai][1][m][1];
          u32x4 w; w.x = cvt_pk_bf16(a0[0], a0[1]); w.y = cvt_pk_bf16(a0[2], a0[3]); w.z = cvt_pk_bf16(a1[0], a1[1]); w.w = cvt_pk_bf16(a1[2], a1[3]);
          *(u32x4*)((bf16_t*)(ws + WS_Z) + (size_t)row * 1024 + colb) = w; }
    } else {
      size_t wo; int ld, colt; bool sig;
      if (pn < 12) { wo = WS_V; ld = 1024; colt = (pn - 8) * 256; sig = false; }
      else if (pn < 24) { wo = WS_CB; ld = 1024; colt = (pn - 20) * 256; sig = false; }
      else if (pn < 32) { wo = WS_SGA; ld = 2048; colt = (pn - 24) * 256; sig = true; }
      else { wo = WS_SGC; ld = 2048; colt = (pn - 32) * 256; sig = true; }
      bf16_t* dst = (bf16_t*)(ws + wo);
#pragma unroll
      for (int ai = 0; ai < 2; ++ai)
#pragma unroll
        for (int m = 0; m < 4; ++m) { const int row = row0 + ai * 128 + m * 16; bf16_t* rp = dst + (size_t)row * ld + colt + c8;
#pragma unroll
          for (int bj = 0; bj < 2; ++bj) { f32x4 a0 = acc[ai][bj][m][0], a1 = acc[ai][bj][m][1];
            if (sig) {
#pragma unroll
              for (int j = 0; j < 4; ++j) { a0[j] = fast_sigmoid(a0[j]); a1[j] = fast_sigmoid(a1[j]); } }
            u32x4 w; w.x = cvt_pk_bf16(a0[0], a0[1]); w.y = cvt_pk_bf16(a0[2], a0[3]); w.z = cvt_pk_bf16(a1[0], a1[1]); w.w = cvt_pk_bf16(a1[2], a1[3]);
            *(u32x4*)(rp + bj * 128) = w; } }
    }
  } };

struct SchedP3 { int G, c; const char *O, *Y, *BA, *BC;
  __device__ __forceinline__ bool next(int i, Unit& u) const { const int L = (i >> 1) * G + c; if (L >= 64 * 8) return false; pg8::order_map(L, 64, 8, u.pm, u.pn); u.seg = i & 1;
    u.A = (u.seg ? Y : O) + (size_t)u.pm * 256 * 1024 * 2; u.B = (u.seg ? BC : BA) + (size_t)u.pn * 256 * 1024 * 2; u.e = 0; u.row0 = 0; u.cnt = 0; return true; }
  __device__ __forceinline__ void offsets(const Unit&, const int (&R)[2], const int (&C)[2], unsigned& o00, unsigned& o01, unsigned& o10, unsigned& o11) const { OffPlain{1024}(R, C, o00, o01, o10, o11); } };
struct EpiP3 { const bf16_t *sga, *sgc; bf16_t* merged;
  __device__ __forceinline__ bool carry(const Unit& u) const { return u.seg == 0; }
  __device__ __forceinline__ void operator()(f32x4 (&acc)[2][2][4][2], const Unit& u, int wr, int wc, int fr, int fq) const {
    const int row0 = u.pm * 256 + wr * 64 + fr, col0 = u.pn * 256 + wc * 32 + fq * 8;
#pragma unroll
    for (int ai = 0; ai < 2; ++ai)
#pragma unroll
      for (int m = 0; m < 4; ++m) { const size_t off = (size_t)(row0 + ai * 128 + m * 16) * DM + col0;
#pragma unroll
        for (int bj = 0; bj < 2; ++bj) { const u32x4 gc = *(const u32x4*)(sgc + off + bj * 128);
          const f32x4 c0 = {bflo(gc.x), bfhi(gc.x), bflo(gc.y), bfhi(gc.y)}, c1 = {bflo(gc.z), bfhi(gc.z), bflo(gc.w), bfhi(gc.w)};
          if (u.seg == 0) { const u32x4 ga = *(const u32x4*)(sga + off + bj * 128);
            const f32x4 a0 = {bflo(ga.x), bfhi(ga.x), bflo(ga.y), bfhi(ga.y)}, a1 = {bflo(ga.z), bfhi(ga.z), bflo(ga.w), bfhi(ga.w)};
#pragma unroll
            for (int j = 0; j < 4; ++j) { acc[ai][bj][m][0][j] *= a0[j] * __builtin_amdgcn_rcpf(fmaxf(c0[j], 1e-30f)); acc[ai][bj][m][1][j] *= a1[j] * __builtin_amdgcn_rcpf(fmaxf(c1[j], 1e-30f)); }
          } else { const f32x4 r0 = acc[ai][bj][m][0] * c0, r1 = acc[ai][bj][m][1] * c1;
            u32x4 w; w.x = cvt_pk_bf16(r0[0], r0[1]); w.y = cvt_pk_bf16(r0[2], r0[3]); w.z = cvt_pk_bf16(r1[0], r1[1]); w.w = cvt_pk_bf16(r1[2], r1[3]);
            *(u32x4*)(merged + off + bj * 128) = w; } } }
  } };

struct SchedP4 { int G, c; const char *A, *B;
  __device__ __forceinline__ bool next(int i, Unit& u) const { const int L = i * G + c; if (L >= 64 * 8) return false; pg8::order_map(L, 64, 8, u.pm, u.pn);
    u.A = A + (size_t)u.pm * 256 * DM * 2; u.B = B + (size_t)u.pn * 256 * DM * 2; u.e = 0; u.seg = 0; u.row0 = 0; u.cnt = 0; return true; }
  __device__ __forceinline__ void offsets(const Unit&, const int (&R)[2], const int (&C)[2], unsigned& o00, unsigned& o01, unsigned& o10, unsigned& o11) const { OffPlain{DM}(R, C, o00, o01, o10, o11); } };
struct EpiP4 { const float *x, *stats0, *g0, *b0; float* r1;
  __device__ __forceinline__ bool carry(const Unit&) const { return false; }
  __device__ __forceinline__ void operator()(const f32x4 (&acc)[2][2][4][2], const Unit& u, int wr, int wc, int fr, int fq) const {
    const int row0 = u.pm * 256 + wr * 64 + fr, col0 = u.pn * 256 + wc * 32 + fq * 8;
#pragma unroll
    for (int ai = 0; ai < 2; ++ai)
#pragma unroll
      for (int m = 0; m < 4; ++m) { const int row = row0 + ai * 128 + m * 16; const float mean = stats0[2 * row], rstd = stats0[2 * row + 1]; const size_t off = (size_t)row * DM + col0;
#pragma unroll
        for (int bj = 0; bj < 2; ++bj)
#pragma unroll
          for (int n = 0; n < 2; ++n) { const int cc = bj * 128 + n * 4; const f32x4 xv = *(const f32x4*)(x + off + cc), gv = *(const f32x4*)(g0 + col0 + cc), bv = *(const f32x4*)(b0 + col0 + cc);
            const f32x4 h = (xv - mean) * rstd * gv + bv; *(f32x4*)(r1 + off + cc) = h * ALPHA + acc[ai][bj][m][n]; }
        asm volatile("" ::: "memory"); }
  } };

struct MoeTab { const LAS int* tstart; const LAS int* cnt; int TT; };
struct SchedMoe { int G, c, nN, K; MoeTab tb; const char* Abase; const char* Bbase; size_t Bexp; const int* list; bool gather;
  __device__ __forceinline__ bool next(int i, Unit& u) const { const int L = i * G + c; if (L >= tb.TT * nN) return false; int pmg, pn; pg8::order_map(L, tb.TT, nN, pmg, pn);
    int e = 0;
#pragma unroll 8
    for (int j = 1; j <= 64; ++j) e += (tb.tstart[j] <= pmg) ? 1 : 0;
    e = __builtin_amdgcn_readfirstlane(e); const int ts = __builtin_amdgcn_readfirstlane(tb.tstart[e]); const int mt = pmg - ts;
    u.e = e; u.pm = mt; u.pn = pn; u.seg = 0; u.cnt = __builtin_amdgcn_readfirstlane(tb.cnt[e]); u.row0 = (e < 64 ? ts * 256 : 0) + mt * 256;
    u.B = Bbase + (size_t)e * Bexp + (size_t)pn * 256 * K * 2;
    u.A = gather ? Abase : (Abase + (e < 64 ? (size_t)0 : (size_t)(WS_HBSH - WS_HB)) + (size_t)u.row0 * K * 2);
    return true; }
  __device__ __forceinline__ void offsets(const Unit& u, const int (&R)[2], const int (&C)[2], unsigned& o00, unsigned& o01, unsigned& o10, unsigned& o11) const {
    if (!gather) { OffPlain{K}(R, C, o00, o01, o10, o11); return; }
    int t00, t01, t10, t11;
    if (u.e < 64) { const int* lp = list + (size_t)u.e * NTOK; const int s0 = u.pm * 256 + R[0], s1 = u.pm * 256 + R[1];
      t00 = s0 < u.cnt ? (lp[s0] >> 3) : 0; t01 = s1 < u.cnt ? (lp[s1] >> 3) : 0; t10 = (s0 + 128) < u.cnt ? (lp[s0 + 128] >> 3) : 0; t11 = (s1 + 128) < u.cnt ? (lp[s1 + 128] >> 3) : 0;
    } else { t00 = u.pm * 256 + R[0]; t01 = u.pm * 256 + R[1]; t10 = t00 + 128; t11 = t01 + 128; }
    o00 = (unsigned)(t00 * K + C[0]) * 2u; o01 = (unsigned)(t01 * K + C[1]) * 2u; o10 = (unsigned)(t10 * K + C[0]) * 2u; o11 = (unsigned)(t11 * K + C[1]) * 2u; } };
struct EpiP6 { bf16_t* hb;
  __device__ __forceinline__ bool carry(const Unit&) const { return false; }
  __device__ __forceinline__ void operator()(const f32x4 (&acc)[2][2][4][2], const Unit& u, int wr, int wc, int fr, int fq) const {
    bf16_t* base = hb + (u.e < 64 ? (size_t)0 : (size_t)(WS_HBSH - WS_HB) / 2) + (size_t)(u.row0 + wr * 64 + fr) * DE + u.pn * 128 + wc * 32 + fq * 8;
#pragma unroll
    for (int ai = 0; ai < 2; ++ai)
#pragma unroll
      for (int m = 0; m < 4; ++m) { f32x4 r0, r1;
#pragma unroll
        for (int j = 0; j < 4; ++j) { const float g0 = acc[ai][0][m][0][j], g1 = acc[ai][0][m][1][j]; r0[j] = g0 * fast_sigmoid(g0) * acc[ai][1][m][0][j]; r1[j] = g1 * fast_sigmoid(g1) * acc[ai][1][m][1][j]; }
        u32x4 w; w.x = cvt_pk_bf16(r0[0], r0[1]); w.y = cvt_pk_bf16(r0[2], r0[3]); w.z = cvt_pk_bf16(r1[0], r1[1]); w.w = cvt_pk_bf16(r1[2], r1[3]);
        *(u32x4*)(base + (size_t)(ai * 128 + m * 16) * DE) = w; }
  } };
struct EpiP7 { bf16_t* yk; const int* list; const bf16_t* h1; float* pre;
  __device__ __forceinline__ bool carry(const Unit&) const { return false; }
  __device__ __forceinline__ void operator()(const f32x4 (&acc)[2][2][4][2], const Unit& u, int wr, int wc, int fr, int fq) const {
    const int col0 = u.pn * 256 + wc * 32 + fq * 8;
    if (u.e < 64) { const int* lp = list + (size_t)u.e * NTOK;
#pragma unroll
      for (int ai = 0; ai < 2; ++ai)
#pragma unroll
        for (int m = 0; m < 4; ++m) { const int s = u.pm * 256 + ai * 128 + wr * 64 + m * 16 + fr;
          if (s < u.cnt) { const int tk = lp[s]; bf16_t* rp = yk + (size_t)tk * DM + col0;
#pragma unroll
            for (int bj = 0; bj < 2; ++bj) { const f32x4 a0 = acc[ai][bj][m][0], a1 = acc[ai][bj][m][1];
              u32x4 w; w.x = cvt_pk_bf16(a0[0], a0[1]); w.y = cvt_pk_bf16(a0[2], a0[3]); w.z = cvt_pk_bf16(a1[0], a1[1]); w.w = cvt_pk_bf16(a1[2], a1[3]);
              *(u32x4*)(rp + bj * 128) = w; } } }
    } else {
#pragma unroll
      for (int ai = 0; ai < 2; ++ai)
#pragma unroll
        for (int m = 0; m < 4; ++m) { const int row = u.pm * 256 + ai * 128 + wr * 64 + m * 16 + fr; const size_t off = (size_t)row * DM + col0;
#pragma unroll
          for (int bj = 0; bj < 2; ++bj) { const u32x4 hv = *(const u32x4*)(h1 + off + bj * 128);
            const f32x4 h0 = {bflo(hv.x), bfhi(hv.x), bflo(hv.y), bfhi(hv.y)}, hh = {bflo(hv.z), bfhi(hv.z), bflo(hv.w), bfhi(hv.w)};
            *(f32x4*)(pre + off + bj * 128) = h0 * ALPHA + acc[ai][bj][m][0]; *(f32x4*)(pre + off + bj * 128 + 4) = hh * ALPHA + acc[ai][bj][m][1]; } }
    }
  } };

__device__ __forceinline__ void p0_tr_item(const float* W, int ldw, int col0, int k0, bf16_t* dst, int ldd, LAS float* scr, int lane) {
#pragma unroll 8
  for (int i = 0; i < 32; ++i) { const int kk = 2 * i + (lane >> 5); scr[kk * 33 + (lane & 31)] = W[(size_t)(k0 + kk) * ldw + col0 + (lane & 31)]; }
  LDS_WAIT(); asm volatile("" ::: "memory");
  const int c = lane & 7;
#pragma unroll
  for (int j = 0; j < 4; ++j) { const int n = (lane >> 3) + 8 * j; const LAS float* s = scr + (8 * c) * 33 + n;
    u32x4 o; o.x = cvt_pk_bf16(s[0 * 33], s[1 * 33]); o.y = cvt_pk_bf16(s[2 * 33], s[3 * 33]); o.z = cvt_pk_bf16(s[4 * 33], s[5 * 33]); o.w = cvt_pk_bf16(s[6 * 33], s[7 * 33]);
    *(u32x4*)(dst + (size_t)n * ldd + k0 + 8 * c) = o; }
  LDS_WAIT(); asm volatile("" ::: "memory");
}
__device__ __forceinline__ int win_col(int n0) {
  const int pn = n0 >> 8, p = n0 & 255, bj = p >> 7, idx = p & 127;
  if (pn < 8) return pn * 256 + (idx >> 5) * 64 + bj * 32;
  if (pn >= 12 && pn < 20) return (bj ? 4096 : 3072) + (pn - 12) * 128 + idx;
  if (pn >= 20) return 5120 + (pn - 20) * 256 + p;
  return n0;
}
__device__ __forceinline__ void p0_prologue(const Params& p, LAS unsigned char* lds) {
  const int tid = threadIdx.x, lane = tid & 63, wave = __builtin_amdgcn_readfirstlane(tid >> 6);
  const int G = gridDim.x, gw = blockIdx.x * 8 + wave, NGW = G * 8;
  unsigned char* ws = p.ws;
  LAS float* scr = (LAS float*)(lds + wave * 16384);
  constexpr int I_WINT = 32 * 320, I_PA = 16 * 64, I_WO = 32 * 64, I_GU = 32 * 32, I_D = 8 * 64, I_R = 64;
  constexpr int NITEMS = I_WINT + 2 * I_PA + I_WO + 65 * I_GU + 65 * I_D + I_R;
  for (int it = gw; it < NITEMS; it += NGW) {
    int r = it;
    if (r < I_WINT) { const int kb = r / 320, nb = r % 320; p0_tr_item(p.in[I_WIN], INC, win_col(nb * 32), kb * 64, (bf16_t*)(ws + WS_WINT) + (size_t)nb * 32 * DM, DM, scr, lane); continue; } r -= I_WINT;
    if (r < I_PA) { const int kb = r / 64, nb = r % 64; p0_tr_item(p.in[I_WPA], DM, nb * 32, kb * 64, (bf16_t*)(ws + WS_WPA) + (size_t)nb * 32 * 1024, 1024, scr, lane); continue; } r -= I_PA;
    if (r < I_PA) { const int kb = r / 64, nb = r % 64; p0_tr_item(p.in[I_WPC], DM, nb * 32, kb * 64, (bf16_t*)(ws + WS_WPC) + (size_t)nb * 32 * 1024, 1024, scr, lane); continue; } r -= I_PA;
    if (r < I_WO) { const int kb = r / 64, nb = r % 64; p0_tr_item(p.in[I_WOUT], DM, nb * 32, kb * 64, (bf16_t*)(ws + WS_WOUT) + (size_t)nb * 32 * DM, DM, scr, lane); continue; } r -= I_WO;
    if (r < 65 * I_GU) { const int e = r / I_GU, q = r % I_GU, kb = q / 32, nb = q % 32;
      const int n0 = nb * 32, col = (n0 >> 8) * 128 + (n0 & 127), up = (n0 >> 7) & 1;
      const float* src = e < 64 ? (up ? p.in[I_WEU] : p.in[I_WEG]) + (size_t)e * DM * DE : (up ? p.in[I_WSU] : p.in[I_WSG]);
      p0_tr_item(src, DE, col, kb * 64, (bf16_t*)(ws + WS_WGU) + ((size_t)e * 1024 + n0) * DM, DM, scr, lane); continue; } r -= 65 * I_GU;
    if (r < 65 * I_D) { const int e = r / I_D, q = r % I_D, kb = q / 64, nb = q % 64;
      const float* src = e < 64 ? p.in[I_WED] + (size_t)e * DE * DM : p.in[I_WSD];
      p0_tr_item(src, DM, nb * 32, kb * 64, (bf16_t*)(ws + WS_WD) + ((size_t)e * DM + nb * 32) * DE, DE, scr, lane); continue; } r -= 65 * I_D;
    {
      const int kb = r >> 1, nb = r & 1, k0 = kb * 64; const float* W = p.in[I_WR];
#pragma unroll 8
      for (int i = 0; i < 32; ++i) { const int kk = 2 * i + (lane >> 5); scr[kk * 33 + (lane & 31)] = W[(size_t)(k0 + kk) * NE + nb * 32 + (lane & 31)]; }
      LDS_WAIT(); asm volatile("" ::: "memory");
      const int c = lane & 7;
#pragma unroll
      for (int j = 0; j < 4; ++j) { const int n = (lane >> 3) + 8 * j; const LAS float* s = scr + (8 * c) * 33 + n; unsigned hi[8], lo[8];
#pragma unroll
        for (int q = 0; q < 8; ++q) { const float v = s[q * 33]; hi[q] = f2bf(v); lo[q] = f2bf(v - bf2f(hi[q])); }
        u32x4 oh = {hi[0] | (hi[1] << 16), hi[2] | (hi[3] << 16), hi[4] | (hi[5] << 16), hi[6] | (hi[7] << 16)}, ol = {lo[0] | (lo[1] << 16), lo[2] | (lo[3] << 16), lo[4] | (lo[5] << 16), lo[6] | (lo[7] << 16)};
        *(u32x4*)((bf16_t*)(ws + WS_WRH) + (size_t)(nb * 32 + n) * DM + k0 + 8 * c) = oh; *(u32x4*)((bf16_t*)(ws + WS_WRL) + (size_t)(nb * 32 + n) * DM + k0 + 8 * c) = ol; }
      LDS_WAIT(); asm volatile("" ::: "memory"); }
  }
  { const float* g0 = p.in[I_LN0G]; const float* b0 = p.in[I_LN0B]; float* st = (float*)(ws + WS_STATS0); bf16_t* hb = (bf16_t*)(ws + WS_HBUF);
    for (int m = gw; m < NTOK; m += NGW) { const f32x4* xr = (const f32x4*)(p.in[I_X] + (size_t)m * DM) + lane; f32x4 v[8]; float s = 0.f;
#pragma unroll
      for (int j = 0; j < 8; ++j) { v[j] = xr[64 * j]; s += (v[j][0] + v[j][1]) + (v[j][2] + v[j][3]); }
      const float mean = wave_sum(s) * (1.f / DM); float s2 = 0.f;
#pragma unroll
      for (int j = 0; j < 8; ++j) { v[j] = v[j] - mean; s2 += (v[j][0] * v[j][0] + v[j][1] * v[j][1]) + (v[j][2] * v[j][2] + v[j][3] * v[j][3]); }
      const float rstd = 1.f / sqrtf(wave_sum(s2) * (1.f / DM) + LN_EPS);
      if (lane == 0) { st[2 * m] = mean; st[2 * m + 1] = rstd; }
      u32x2* o8 = (u32x2*)(hb + (size_t)m * DM) + lane;
#pragma unroll
      for (int j = 0; j < 8; ++j) { const f32x4 g = ((const f32x4*)g0)[lane + 64 * j], b = ((const f32x4*)b0)[lane + 64 * j]; const f32x4 h = v[j] * rstd * g + b;
        u32x2 w; w.x = cvt_pk_bf16(h[0], h[1]); w.y = cvt_pk_bf16(h[2], h[3]); o8[64 * j] = w; } } }
  { float* cs = (float*)(ws + WS_ROPE); float* sn = cs + (size_t)NPOS * 32;
    for (int i = blockIdx.x * 512 + tid; i < NPOS * 32; i += G * 512) { const int pos = i >> 5, f = i & 31; const float ang = (float)pos * INV_FREQ[f];
      const double rev = (double)ang * 0.15915494309189535; const float fr = (float)(rev - __builtin_floor(rev));
      cs[i] = __builtin_amdgcn_cosf(fr); sn[i] = __builtin_amdgcn_sinf(fr); } }
  if (blockIdx.x == 0 && wave == 0) { const float a = wave_sum(p.in[I_LQ1][lane] * p.in[I_LK1][lane]), b = wave_sum(p.in[I_LQ2][lane] * p.in[I_LK2][lane]);
    if (lane == 0) ((float*)(ws + WS_SCAL))[0] = __expf(a) - __expf(b) + LAM_INIT; }
  __syncthreads();
  { LAS float* hm = (LAS float*)lds;
    const float* g0 = p.in[I_LN0G]; const float* b0 = p.in[I_LN0B];
    for (int r = wave; r < 16; r += 8) { const f32x4* xr = (const f32x4*)(p.in[I_META] + (size_t)r * DM) + lane; f32x4 v[8]; float s = 0.f;
#pragma unroll
      for (int j = 0; j < 8; ++j) { v[j] = xr[64 * j]; s += (v[j][0] + v[j][1]) + (v[j][2] + v[j][3]); }
      const float mean = wave_sum(s) * (1.f / DM); float s2 = 0.f;
#pragma unroll
      for (int j = 0; j < 8; ++j) { v[j] = v[j] - mean; s2 += (v[j][0] * v[j][0] + v[j][1] * v[j][1]) + (v[j][2] * v[j][2] + v[j][3] * v[j][3]); }
      const float rstd = 1.f / sqrtf(wave_sum(s2) * (1.f / DM) + LN_EPS);
#pragma unroll
      for (int j = 0; j < 8; ++j) { const f32x4 g = ((const f32x4*)g0)[lane + 64 * j], b = ((const f32x4*)b0)[lane + 64 * j]; const f32x4 h = v[j] * rstd * g + b;
        LAS float* d = hm + r * 2049 + (lane + 64 * j) * 4; d[0] = h[0]; d[1] = h[1]; d[2] = h[2]; d[3] = h[3]; } }
    __syncthreads();
    LAS float* part = hm + 16 * 2049;
    for (int cb = blockIdx.x; cb < 256; cb += G) { const int row = tid & 15, cj = (tid >> 4) & 15, kh = tid >> 8; const float* wp = p.in[I_WIN] + (size_t)(kh * 1024) * INC + 1024 + cb * 16 + cj; const LAS float* hp = hm + row * 2049 + kh * 1024;
      float a = 0.f;
#pragma unroll 8
      for (int k = 0; k < 1024; ++k) a = fmaf(hp[k], wp[(size_t)k * INC], a);
      part[kh * 256 + (tid & 255)] = a; __syncthreads();
      if (tid < 256) ((float*)(ws + WS_UMETA))[(size_t)row * 4096 + cb * 16 + cj] = part[tid] + part[256 + tid];
      __syncthreads(); } }
}
__device__ __forceinline__ void p1_meta_finalize(const Params& p) {
  unsigned char* ws = p.ws; const float* um = (const float*)(ws + WS_UMETA); const float* cs = (const float*)(ws + WS_ROPE); const float* sn = cs + (size_t)NPOS * 32;
  for (int r = blockIdx.x; r < 16; r += gridDim.x) { const int t = threadIdx.x; const float* u = um + (size_t)r * 4096;
    { const int hh = t >> 5, i = t & 31; const float x1 = u[hh * 64 + i], x2 = u[hh * 64 + 32 + i], c = cs[r * 32 + i], s = sn[r * 32 + i];
      bf16_t* kd = (bf16_t*)(ws + WS_KMETA) + (size_t)r * 1024 + hh * 64 + i; kd[0] = (bf16_t)f2bf(x1 * c - x2 * s); kd[32] = (bf16_t)f2bf(x2 * c + x1 * s); }
    bf16_t* vd = (bf16_t*)(ws + WS_VMETA) + (size_t)r * 1024; vd[t] = (bf16_t)f2bf(u[1024 + t]); vd[t + 512] = (bf16_t)f2bf(u[1024 + t + 512]);
    if (r >= 14) { float* zd = (float*)(ws + WS_ZMETA) + (size_t)(r - 14) * 1024; zd[t] = bf2f(f2bf(u[2048 + t] * u[3072 + t])); zd[t + 512] = bf2f(f2bf(u[2048 + t + 512] * u[3072 + t + 512])); } }
}

__device__ __forceinline__ void p2_conv(const Params& p) {
  unsigned char* ws = p.ws; const bf16_t* z = (const bf16_t*)(ws + WS_Z); const bf16_t* cb = (const bf16_t*)(ws + WS_CB); bf16_t* y = (bf16_t*)(ws + WS_Y);
  const float* zm = (const float*)(ws + WS_ZMETA); const float* wc = p.in[I_WCONV];
  for (size_t it = (size_t)blockIdx.x * 512 + threadIdx.x; it < (size_t)NTOK * 128; it += (size_t)gridDim.x * 512) { const int row = (int)(it >> 7), c0 = (int)(it & 127) * 8, t = row & (SEQ - 1);
    float z0[8], z1[8], z2[8], cv[8];
    { const u32x4 a = *(const u32x4*)(z + (size_t)row * 1024 + c0); z0[0] = bflo(a.x); z0[1] = bfhi(a.x); z0[2] = bflo(a.y); z0[3] = bfhi(a.y); z0[4] = bflo(a.z); z0[5] = bfhi(a.z); z0[6] = bflo(a.w); z0[7] = bfhi(a.w); }
    { const u32x4 a = *(const u32x4*)(cb + (size_t)row * 1024 + c0); cv[0] = bflo(a.x); cv[1] = bfhi(a.x); cv[2] = bflo(a.y); cv[3] = bfhi(a.y); cv[4] = bflo(a.z); cv[5] = bfhi(a.z); cv[6] = bflo(a.w); cv[7] = bfhi(a.w); }
    if (t >= 1) { const u32x4 a = *(const u32x4*)(z + (size_t)(row - 1) * 1024 + c0); z1[0] = bflo(a.x); z1[1] = bfhi(a.x); z1[2] = bflo(a.y); z1[3] = bfhi(a.y); z1[4] = bflo(a.z); z1[5] = bfhi(a.z); z1[6] = bflo(a.w); z1[7] = bfhi(a.w); }
    else {
#pragma unroll
      for (int j = 0; j < 8; ++j) z1[j] = zm[1024 + c0 + j]; }
    if (t >= 2) { const u32x4 a = *(const u32x4*)(z + (size_t)(row - 2) * 1024 + c0); z2[0] = bflo(a.x); z2[1] = bfhi(a.x); z2[2] = bflo(a.y); z2[3] = bfhi(a.y); z2[4] = bflo(a.z); z2[5] = bfhi(a.z); z2[6] = bflo(a.w); z2[7] = bfhi(a.w); }
    else {
#pragma unroll
      for (int j = 0; j < 8; ++j) z2[j] = zm[(t == 1 ? 1024 : 0) + c0 + j]; }
    float r[8];
#pragma unroll
    for (int j = 0; j < 8; ++j) r[j] = cv[j] * (wc[c0 + j] * z2[j] + wc[1024 + c0 + j] * z1[j] + wc[2048 + c0 + j] * z0[j]);
    u32x4 w; w.x = cvt_pk_bf16(r[0], r[1]); w.y = cvt_pk_bf16(r[2], r[3]); w.z = cvt_pk_bf16(r[4], r[5]); w.w = cvt_pk_bf16(r[6], r[7]);
    *(u32x4*)(y + (size_t)row * 1024 + c0) = w; }
}

namespace att {
constexpr float CS = 0.125f * 1.4426950408889634f;
constexpr float NEG = -1e30f;
constexpr int KB = 16384;
#define KSWZ(row, colB) ((row) * 256 + ((colB) ^ (((row) & 7) << 4)))
#define SBAR() __builtin_amdgcn_sched_barrier(0)
__device__ __forceinline__ int crow(int r, int hi) { return (r & 3) + 8 * (r >> 2) + 4 * hi; }
__device__ __forceinline__ int v_st(int k, int c) { const int kk = (k & ~0xC) | ((k & 4) << 1) | ((k & 8) >> 1); return ((kk >> 3) * 4 + (c >> 5)) * 512 + ((kk & 7) * 32 + (c & 31)) * 2; }
__device__ __forceinline__ int v_rd_base(int lane) { return ((lane & 3) << 3) | (((lane >> 2) & 3) << 6) | (((lane >> 4) & 1) << 5) | (((lane >> 5) & 1) << 8); }
constexpr int v_rd_off(int d0, int ks, int half) { return d0 * 512 + ks * 4096 + half * 2048; }
template <int OFF> __device__ __forceinline__ s16x4 tr_read(unsigned vb) { s16x4 r; asm volatile("ds_read_b64_tr_b16 %0, %1 offset:%2" : "=&v"(r) : "v"(vb), "i"(OFF) : "memory"); return r; }
template <int D0> __device__ __forceinline__ void pv_one(f32x16& od, unsigned vb, bf16x8 pa0, bf16x8 pa1, bf16x8 pa2, bf16x8 pa3) {
  const s16x4 l0 = tr_read<v_rd_off(D0, 0, 0)>(vb), h0 = tr_read<v_rd_off(D0, 0, 1)>(vb), l1 = tr_read<v_rd_off(D0, 1, 0)>(vb), h1 = tr_read<v_rd_off(D0, 1, 1)>(vb);
  const s16x4 l2 = tr_read<v_rd_off(D0, 2, 0)>(vb), h2 = tr_read<v_rd_off(D0, 2, 1)>(vb), l3 = tr_read<v_rd_off(D0, 3, 0)>(vb), h3 = tr_read<v_rd_off(D0, 3, 1)>(vb);
  asm volatile("s_waitcnt lgkmcnt(0)" ::: "memory"); SBAR();
#define PK(L, H) (bf16x8){L[0], L[1], L[2], L[3], H[0], H[1], H[2], H[3]}
  od = __builtin_amdgcn_mfma_f32_32x32x16_bf16(pa0, PK(l0, h0), od, 0, 0, 0);
  od = __builtin_amdgcn_mfma_f32_32x32x16_bf16(pa1, PK(l1, h1), od, 0, 0, 0);
  od = __builtin_amdgcn_mfma_f32_32x32x16_bf16(pa2, PK(l2, h2), od, 0, 0, 0);
  od = __builtin_amdgcn_mfma_f32_32x32x16_bf16(pa3, PK(l3, h3), od, 0, 0, 0);
#undef PK
}
__device__ __forceinline__ void qkt_half(f32x16& s0, f32x16& s1, const LAS char* Ks, int kb, const bf16x8 (&qr)[8], int r32, int hi) {
  s0 = f32x16{}; s1 = f32x16{};
#pragma unroll
  for (int d0 = 0; d0 < 4; ++d0) { const int cb = (d0 * 16 + hi * 8) * 2;
    const bf16x8 k0 = *(const LAS bf16x8*)(Ks + KSWZ(kb * 32 + r32, cb));
    s0 = __builtin_amdgcn_mfma_f32_32x32x16_bf16(k0, qr[d0], s0, 0, 0, 0); }
#pragma unroll
  for (int d0 = 4; d0 < 8; ++d0) { const int cb = (d0 * 16 + hi * 8) * 2;
    const bf16x8 k0 = *(const LAS bf16x8*)(Ks + KSWZ(kb * 32 + r32, cb));
    s1 = __builtin_amdgcn_mfma_f32_32x32x16_bf16(k0, qr[d0], s1, 0, 0, 0); }
}
__device__ __forceinline__ void mask_meta(f32x16& a, int kb) {
#pragma unroll
  for (int r = 0; r < 16; ++r) if (kb == 1 || r >= 8) a[r] = NEG;
}
__device__ __forceinline__ float half_max(float v) { auto rr = __builtin_amdgcn_permlane32_swap(__float_as_uint(v), __float_as_uint(v), false, false); return fmaxf(__uint_as_float(rr[0]), __uint_as_float(rr[1])); }
__device__ __forceinline__ float half_sum(float v) { auto rr = __builtin_amdgcn_permlane32_swap(__float_as_uint(v), __float_as_uint(v), false, false); return __uint_as_float(rr[0]) + __uint_as_float(rr[1]); }
__device__ __forceinline__ void stats_update(const f32x16& a, float& m, float& l) {
  float pmax = a[0];
#pragma unroll
  for (int r = 1; r < 16; ++r) pmax = fmaxf(pmax, a[r]);
  pmax = half_max(pmax);
  const float mn = fmaxf(m, pmax), al = __builtin_amdgcn_exp2f((m - mn) * CS), mc = -mn * CS; float ps = 0.f;
#pragma unroll
  for (int r = 0; r < 16; ++r) ps += __builtin_amdgcn_exp2f(fmaf(a[r], CS, mc));
  ps = half_sum(ps);
  l = l * al + ps; m = mn;
}
__device__ __forceinline__ void attn_unit(const Params& p, LAS char* lds, int b, int h, int j, float lam) {
  unsigned char* ws = p.ws;
  const int tid = threadIdx.x, wid = __builtin_amdgcn_readfirstlane(tid >> 6), lane = tid & 63, r32 = lane & 31, hi = lane >> 5;
  const bf16_t* Qb = (const bf16_t*)(ws + WS_Q) + ((size_t)b * SEQ + j * 256) * QKW + h * 128;
  const bf16_t* Kh = (const bf16_t*)(ws + WS_K) + (size_t)b * SEQ * QKW + h * 128;
  const bf16_t* Vh = (const bf16_t*)(ws + WS_V) + (size_t)b * SEQ * QKW + h * 128;
  const bf16_t* Km = (const bf16_t*)(ws + WS_KMETA) + h * 128; const bf16_t* Vm = (const bf16_t*)(ws + WS_VMETA) + h * 128;
  LAS char* K_lds = lds; LAS char* V_lds = lds + 2 * KB;
  const int NT = 4 * j + 5;
  const int mytiles = 4 * j + (wid >> 1) + 2;
  bf16x8 qr[8];
  { const bf16_t* Qw = Qb + (size_t)(wid * 32 + r32) * QKW + hi * 8;
#pragma unroll
    for (int d0 = 0; d0 < 8; ++d0) qr[d0] = *(const bf16x8*)(Qw + d0 * 16); }
  const int sr = tid >> 4, sc = (tid & 15) * 8; const unsigned goff = (unsigned)(sr * QKW + sc) * 2u;
  const int vst0 = v_st(sr, sc), vst1 = v_st(32 + sr, sc), kst0 = KSWZ(sr, sc * 2), kst1 = KSWZ(32 + sr, sc * 2);
  bf16x8 ks0, ks1, vs0, vs1;
#define KLOAD(tt) do { const char* kb_ = (const char*)((tt) == 0 ? Km : Kh + (size_t)((tt) - 1) * 64 * QKW); ks0 = *(const bf16x8*)(kb_ + goff); ks1 = *(const bf16x8*)(kb_ + 32 * QKW * 2 + goff); } while (0)
#define VLOAD(tt) do { const char* vb_ = (const char*)((tt) == 0 ? Vm : Vh + (size_t)((tt) - 1) * 64 * QKW); vs0 = *(const bf16x8*)(vb_ + goff); vs1 = *(const bf16x8*)(vb_ + 32 * QKW * 2 + goff); } while (0)
#define KWRITE(bb) do { *(LAS bf16x8*)(K_lds + (bb) * KB + kst0) = ks0; *(LAS bf16x8*)(K_lds + (bb) * KB + kst1) = ks1; } while (0)
#define VWRITE(bb) do { *(LAS bf16x8*)(V_lds + (bb) * KB + vst0) = vs0; *(LAS bf16x8*)(V_lds + (bb) * KB + vst1) = vs1; } while (0)
  float m0 = NEG, l0 = 0.f, m1 = NEG, l1 = 0.f;
  KLOAD(0); KWRITE(0); __syncthreads();
  for (int tt = 0; tt < NT; ++tt) {
    if (tt + 1 < NT) KLOAD(tt + 1);
    if (tt < mytiles) {
#pragma unroll
      for (int kb = 0; kb < 2; ++kb) { f32x16 s0, s1; qkt_half(s0, s1, K_lds + (tt & 1) * KB, kb, qr, r32, hi);
        if (tt == 0) { mask_meta(s0, kb); mask_meta(s1, kb); }
        stats_update(s0, m0, l0); stats_update(s1, m1, l1); } }
    if (tt + 1 < NT) KWRITE((tt + 1) & 1);
    __syncthreads();
  }
  const float e0 = -m0 * CS - __builtin_amdgcn_logf(l0), e1 = -m1 * CS, c1 = lam * __builtin_amdgcn_rcpf(l1);
  f32x16 o[4] = {f32x16{}, f32x16{}, f32x16{}, f32x16{}};
  const unsigned vb0 = (unsigned)(uintptr_t)V_lds + (unsigned)v_rd_base(lane);
  KLOAD(0); VLOAD(0); KWRITE(0); VWRITE(0); __syncthreads();
  for (int tt = 0; tt < NT; ++tt) {
    if (tt + 1 < NT) { KLOAD(tt + 1); VLOAD(tt + 1); }
    if (tt < mytiles) { bf16x8 pa0, pa1, pa2, pa3;
#define PK4(P, BASE, OUT) do { unsigned a0 = cvt_pk_bf16(P[BASE + 0], P[BASE + 1]), a1 = cvt_pk_bf16(P[BASE + 2], P[BASE + 3]);   \
    unsigned b0 = cvt_pk_bf16(P[BASE + 4], P[BASE + 5]), b1 = cvt_pk_bf16(P[BASE + 6], P[BASE + 7]);                              \
    auto r0 = __builtin_amdgcn_permlane32_swap(a0, b0, false, false); auto r1 = __builtin_amdgcn_permlane32_swap(a1, b1, false, false); \
    u32x4 w = {r0[0], r1[0], r0[1], r1[1]}; OUT = *reinterpret_cast<bf16x8*>(&w); } while (0)
      { f32x16 s0, s1; qkt_half(s0, s1, K_lds + (tt & 1) * KB, 0, qr, r32, hi);
        if (tt == 0) { mask_meta(s0, 0); mask_meta(s1, 0); }
#pragma unroll
        for (int r = 0; r < 16; ++r) s0[r] = fmaf(-c1, __builtin_amdgcn_exp2f(fmaf(s1[r], CS, e1)), __builtin_amdgcn_exp2f(fmaf(s0[r], CS, e0)));
        PK4(s0, 0, pa0); PK4(s0, 8, pa1); }
      { f32x16 s0, s1; qkt_half(s0, s1, K_lds + (tt & 1) * KB, 1, qr, r32, hi);
        if (tt == 0) { mask_meta(s0, 1); mask_meta(s1, 1); }
#pragma unroll
        for (int r = 0; r < 16; ++r) s0[r] = fmaf(-c1, __builtin_amdgcn_exp2f(fmaf(s1[r], CS, e1)), __builtin_amdgcn_exp2f(fmaf(s0[r], CS, e0)));
        PK4(s0, 0, pa2); PK4(s0, 8, pa3); }
#undef PK4
      SBAR();
      const unsigned vb = vb0 + (unsigned)((tt & 1) * KB);
      pv_one<0>(o[0], vb, pa0, pa1, pa2, pa3); pv_one<1>(o[1], vb, pa0, pa1, pa2, pa3); pv_one<2>(o[2], vb, pa0, pa1, pa2, pa3); pv_one<3>(o[3], vb, pa0, pa1, pa2, pa3); }
    if (tt + 1 < NT) { KWRITE((tt + 1) & 1); VWRITE((tt + 1) & 1); }
    __syncthreads();
  }
#undef KLOAD
#undef VLOAD
#undef KWRITE
#undef VWRITE
  const float* sg = p.in[I_SUBG]; float gsc[4];
#pragma unroll
  for (int d0 = 0; d0 < 4; ++d0) gsc[d0] = sg[d0 * 32 + r32] * (1.0f - LAM_INIT);
  LAS bf16_t* ost = (LAS bf16_t*)(lds + wid * 8192);
#pragma unroll
  for (int r = 0; r < 16; ++r) { float ss = o[0][r] * o[0][r] + o[1][r] * o[1][r] + o[2][r] * o[2][r] + o[3][r] * o[3][r];
#pragma unroll
    for (int x = 1; x < 32; x <<= 1) ss += __shfl_xor(ss, x);
    const float rs = __builtin_amdgcn_rsqf(ss * (1.0f / 128.0f) + LN_EPS); const int row = crow(r, hi);
#pragma unroll
    for (int d0 = 0; d0 < 4; ++d0) ost[row * 128 + d0 * 32 + r32] = (bf16_t)f2bf(o[d0][r] * rs * gsc[d0]); }
  LDS_WAIT(); asm volatile("" ::: "memory");
  bf16_t* Ob = (bf16_t*)(ws + WS_O) + ((size_t)b * SEQ + j * 256 + wid * 32) * 1024 + h * 128;
#pragma unroll
  for (int i = 0; i < 8; ++i) { const int ch = i * 64 + lane, row = ch >> 4, cc = (ch & 15) * 8; *(u32x4*)(Ob + (size_t)row * 1024 + cc) = *(const LAS u32x4*)(ost + row * 128 + cc); }
  LDS_WAIT(); __syncthreads();
}
#undef SBAR
}

__device__ __forceinline__ void p5_route(const Params& p, LAS unsigned char* lds) {
  unsigned char* ws = p.ws; const int tid = threadIdx.x, wid = __builtin_amdgcn_readfirstlane(tid >> 6), lane = tid & 63, r32 = lane & 31, hi = lane >> 5;
  const float* r1 = p.out; const float* g1 = p.in[I_LN1G]; const float* b1 = p.in[I_LN1B];
  bf16_t* h1 = (bf16_t*)(ws + WS_H1); const bf16_t* wrh = (const bf16_t*)(ws + WS_WRH); const bf16_t* wrl = (const bf16_t*)(ws + WS_WRL);
  LAS float* part = (LAS float*)lds;
  LAS float* stl = part + 4 * 64 * 65;
  LAS float* sel = stl + 128;
  LAS float* sg = sel + 64 * 65;
  LAS int* lcnt = (LAS int*)(sg + 64 * 65);
  LAS int* lbase = lcnt + 64;
  for (int tg = blockIdx.x; tg < NTOK / 64; tg += gridDim.x) { const int tok0 = tg * 64;
    for (int q = 0; q < 8; ++q) { const int tl = wid * 8 + q, m = tok0 + tl; const f32x4* xr = (const f32x4*)(r1 + (size_t)m * DM) + lane; f32x4 v[8]; float s = 0.f;
#pragma unroll
      for (int jj = 0; jj < 8; ++jj) { v[jj] = xr[64 * jj]; s += (v[jj][0] + v[jj][1]) + (v[jj][2] + v[jj][3]); }
      const float mean = wave_sum(s) * (1.f / DM); float s2 = 0.f;
#pragma unroll
      for (int jj = 0; jj < 8; ++jj) { v[jj] = v[jj] - mean; s2 += (v[jj][0] * v[jj][0] + v[jj][1] * v[jj][1]) + (v[jj][2] * v[jj][2] + v[jj][3] * v[jj][3]); }
      const float rstd = 1.f / sqrtf(wave_sum(s2) * (1.f / DM) + LN_EPS);
      if (lane == 0) { stl[2 * tl] = mean; stl[2 * tl + 1] = rstd; }
      u32x2* o8 = (u32x2*)(h1 + (size_t)m * DM) + lane;
#pragma unroll
      for (int jj = 0; jj < 8; ++jj) { const f32x4 g = ((const f32x4*)g1)[lane + 64 * jj], bb = ((const f32x4*)b1)[lane + 64 * jj]; const f32x4 hh = v[jj] * rstd * g + bb;
        u32x2 w; w.x = cvt_pk_bf16(hh[0], hh[1]); w.y = cvt_pk_bf16(hh[2], hh[3]); o8[64 * jj] = w; } }
    if (tid < 64) lcnt[tid] = 0;
    __syncthreads();
    { const int th = wid & 1, kq = wid >> 1; const int tl = th * 32 + r32; const float mean = stl[2 * tl], rstd = stl[2 * tl + 1];
      const float* xr = r1 + (size_t)(tok0 + tl) * DM + kq * 512 + hi * 8;
      f32x16 a0 = {}, a1 = {};
      for (int s = 0; s < 32; ++s) { const int k = kq * 512 + s * 16 + hi * 8;
        const f32x4 x0 = *(const f32x4*)(xr + s * 16), x1 = *(const f32x4*)(xr + s * 16 + 4), g0 = *(const f32x4*)(g1 + k), gg1 = *(const f32x4*)(g1 + k + 4), bb0 = *(const f32x4*)(b1 + k), bb1 = *(const f32x4*)(b1 + k + 4);
        const f32x4 v0 = (x0 - mean) * rstd * g0 + bb0, v1 = (x1 - mean) * rstd * gg1 + bb1;
        u32x4 ah, al; float t0, t1;
        ah.x = cvt_pk_bf16(v0[0], v0[1]); t0 = v0[0] - bflo(ah.x); t1 = v0[1] - bfhi(ah.x); al.x = cvt_pk_bf16(t0, t1);
        ah.y = cvt_pk_bf16(v0[2], v0[3]); t0 = v0[2] - bflo(ah.y); t1 = v0[3] - bfhi(ah.y); al.y = cvt_pk_bf16(t0, t1);
        ah.z = cvt_pk_bf16(v1[0], v1[1]); t0 = v1[0] - bflo(ah.z); t1 = v1[1] - bfhi(ah.z); al.z = cvt_pk_bf16(t0, t1);
        ah.w = cvt_pk_bf16(v1[2], v1[3]); t0 = v1[2] - bflo(ah.w); t1 = v1[3] - bfhi(ah.w); al.w = cvt_pk_bf16(t0, t1);
        const bf16x8 Ah = *reinterpret_cast<bf16x8*>(&ah), Al = *reinterpret_cast<bf16x8*>(&al);
        const bf16x8 Bh0 = *(const bf16x8*)(wrh + (size_t)r32 * DM + k), Bh1 = *(const bf16x8*)(wrh + (size_t)(32 + r32) * DM + k), Bl0 = *(const bf16x8*)(wrl + (size_t)r32 * DM + k), Bl1 = *(const bf16x8*)(wrl + (size_t)(32 + r32) * DM + k);
        a0 = __builtin_amdgcn_mfma_f32_32x32x16_bf16(Ah, Bh0, a0, 0, 0, 0); a0 = __builtin_amdgcn_mfma_f32_32x32x16_bf16(Al, Bh0, a0, 0, 0, 0); a0 = __builtin_amdgcn_mfma_f32_32x32x16_bf16(Ah, Bl0, a0, 0, 0, 0);
        a1 = __builtin_amdgcn_mfma_f32_32x32x16_bf16(Ah, Bh1, a1, 0, 0, 0); a1 = __builtin_amdgcn_mfma_f32_32x32x16_bf16(Al, Bh1, a1, 0, 0, 0); a1 = __builtin_amdgcn_mfma_f32_32x32x16_bf16(Ah, Bl1, a1, 0, 0, 0); }
#pragma unroll
      for (int r = 0; r < 16; ++r) { const int trow = th * 32 + att::crow(r, hi); part[(kq * 64 + trow) * 65 + r32] = a0[r]; part[(kq * 64 + trow) * 65 + 32 + r32] = a1[r]; } }
    __syncthreads();
    if (wid == 0) { const int t = lane; const float* rb = p.in[I_RB];
      for (int e = 0; e < 64; ++e) { const float lg = ((part[(0 * 64 + t) * 65 + e] + part[(1 * 64 + t) * 65 + e]) + part[(2 * 64 + t) * 65 + e]) + part[(3 * 64 + t) * 65 + e];
        const float s = 1.0f / (1.0f + __expf(-lg)); sg[t * 65 + e] = s; sel[t * 65 + e] = s + rb[e]; }
      LDS_WAIT();
      float gs[8];
#pragma unroll
      for (int g = 0; g < 8; ++g) { float b1v = -INFINITY, b2v = -INFINITY;
#pragma unroll
        for (int q = 0; q < 8; ++q) { const float v = sel[t * 65 + g * 8 + q]; if (v > b1v) { b2v = b1v; b1v = v; } else if (v > b2v) b2v = v; }
        gs[g] = b1v + b2v; }
      unsigned gmask = 0;
#pragma unroll
      for (int it = 0; it < 4; ++it) { float bv = -INFINITY; int bi = 0;
#pragma unroll
        for (int g = 0; g < 8; ++g) { const bool ok = !((gmask >> g) & 1u) && gs[g] > bv; bv = ok ? gs[g] : bv; bi = ok ? g : bi; }
        gmask |= 1u << bi; }
      unsigned long long chosen = 0; int ei[8]; float es[8]; float ssum = 0.f;
#pragma unroll
      for (int it = 0; it < 8; ++it) { float bv = -INFINITY; int bi = 0;
        for (int e = 0; e < 64; ++e) { const float v = sel[t * 65 + e]; const bool ok = ((gmask >> (e >> 3)) & 1u) && !((chosen >> e) & 1ull) && v > bv; bv = ok ? v : bv; bi = ok ? e : bi; }
        chosen |= 1ull << bi; ei[it] = bi; es[it] = sg[t * 65 + bi]; ssum += es[it]; }
      const float inv = ROUTED_SCALE / ssum; int lp[8];
#pragma unroll
      for (int it = 0; it < 8; ++it) lp[it] = __hip_atomic_fetch_add(&lcnt[ei[it]], 1, __ATOMIC_RELAXED, __HIP_MEMORY_SCOPE_WORKGROUP);
      LDS_WAIT(); asm volatile("" ::: "memory");
      { const int n = lcnt[lane]; int bs = 0; if (n > 0) bs = (int)atomicAdd((unsigned*)(ws + CTL_COUNTS) + lane, (unsigned)n); lbase[lane] = bs; }
      LDS_WAIT(); asm volatile("" ::: "memory");
      float* ewp = (float*)(ws + WS_EW) + (size_t)(tok0 + t) * 8; int* list = (int*)(ws + WS_LIST);
#pragma unroll
      for (int it = 0; it < 8; ++it) { ewp[it] = es[it] * inv; list[(size_t)ei[it] * NTOK + lbase[ei[it]] + lp[it]] = (tok0 + t) * 8 + it; }
    }
    __syncthreads();
  }
}

__device__ __forceinline__ void p8_combine(const Params& p) {
  unsigned char* ws = p.ws; const int lane = threadIdx.x & 63, wave = threadIdx.x >> 6; const int gw = blockIdx.x * 8 + wave, NGW = gridDim.x * 8;
  const bf16_t* yk = (const bf16_t*)(ws + WS_YK); const float* ew = (const float*)(ws + WS_EW); const float* g2 = p.in[I_LN2G]; const float* b2 = p.in[I_LN2B]; float* out = p.out;
  for (int m = gw; m < NTOK; m += NGW) { float v[4][8]; float s = 0.f;
#pragma unroll
    for (int g = 0; g < 4; ++g) { const float* pr = out + (size_t)m * DM + g * 512 + lane * 8; const f32x4 a = *(const f32x4*)pr, b = *(const f32x4*)(pr + 4);
      v[g][0] = a[0]; v[g][1] = a[1]; v[g][2] = a[2]; v[g][3] = a[3]; v[g][4] = b[0]; v[g][5] = b[1]; v[g][6] = b[2]; v[g][7] = b[3]; }
#pragma unroll
    for (int k = 0; k < 8; ++k) { const float w = ew[(size_t)m * 8 + k]; const bf16_t* yr = yk + ((size_t)m * 8 + k) * DM + lane * 8;
#pragma unroll
      for (int g = 0; g < 4; ++g) { const u32x4 a = *(const u32x4*)(yr + g * 512);
        v[g][0] = fmaf(w, bflo(a.x), v[g][0]); v[g][1] = fmaf(w, bfhi(a.x), v[g][1]); v[g][2] = fmaf(w, bflo(a.y), v[g][2]); v[g][3] = fmaf(w, bfhi(a.y), v[g][3]);
        v[g][4] = fmaf(w, bflo(a.z), v[g][4]); v[g][5] = fmaf(w, bfhi(a.z), v[g][5]); v[g][6] = fmaf(w, bflo(a.w), v[g][6]); v[g][7] = fmaf(w, bfhi(a.w), v[g][7]); } }
#pragma unroll
    for (int g = 0; g < 4; ++g)
#pragma unroll
      for (int q = 0; q < 8; ++q) s += v[g][q];
    const float mean = wave_sum(s) * (1.f / DM); float s2 = 0.f;
#pragma unroll
    for (int g = 0; g < 4; ++g)
#pragma unroll
      for (int q = 0; q < 8; ++q) { v[g][q] -= mean; s2 += v[g][q] * v[g][q]; }
    const float rstd = 1.f / sqrtf(wave_sum(s2) * (1.f / DM) + LN_EPS);
#pragma unroll
    for (int g = 0; g < 4; ++g) { const int c = g * 512 + lane * 8; const f32x4 ga = *(const f32x4*)(g2 + c), gb = *(const f32x4*)(g2 + c + 4), ba = *(const f32x4*)(b2 + c), bb = *(const f32x4*)(b2 + c + 4);
      f32x4 oa = {v[g][0] * rstd * ga[0] + ba[0], v[g][1] * rstd * ga[1] + ba[1], v[g][2] * rstd * ga[2] + ba[2], v[g][3] * rstd * ga[3] + ba[3]};
      f32x4 ob = {v[g][4] * rstd * gb[0] + bb[0], v[g][5] * rstd * gb[1] + bb[1], v[g][6] * rstd * gb[2] + bb[2], v[g][7] * rstd * gb[3] + bb[3]};
      *(f32x4*)(out + (size_t)m * DM + c) = oa; *(f32x4*)(out + (size_t)m * DM + c + 4) = ob; } }
}

__device__ __forceinline__ MoeTab moe_tables(const Params& p, LAS unsigned char* lds) {
  LAS int* ts = (LAS int*)(lds + LDSX_OFF); LAS int* cn = ts + 80;
  __syncthreads();
  if (threadIdx.x == 0) { const unsigned* counts = (const unsigned*)(p.ws + CTL_COUNTS); int acc = 0;
    for (int e = 0; e < 64; ++e) { const int c = (int)counts[e]; cn[e] = c; ts[e] = acc; acc += (c + 255) >> 8; }
    cn[64] = NTOK; ts[64] = acc; acc += 64; ts[65] = acc; }
  __syncthreads();
  MoeTab tb; tb.tstart = ts; tb.cnt = cn; tb.TT = __builtin_amdgcn_readfirstlane(ts[65]); return tb;
}

__global__ void __launch_bounds__(512, 2) fwd(Params p) {
  extern __shared__ __attribute__((aligned(16))) unsigned char lds_raw[];
  LAS unsigned char* lds = (LAS unsigned char*)lds_raw;
  cg::grid_group grid = cg::this_grid();
  unsigned char* ws = p.ws;
  const int G = gridDim.x, c = blockIdx.x;
  const int lo = p.ph_lo, hi = p.ph_hi;
#ifndef PHMASK
#define PHMASK 0x1ff
#endif
#define IN(k) (((PHMASK >> (k)) & 1) && lo <= (k) && (k) < hi)
#define SEAM(k) do { if (IN(k) && IN((k) + 1)) grid.sync(); } while (0)
  if (IN(0)) { p0_prologue(p, lds); }
  SEAM(0);
  if (IN(1)) { p1_meta_finalize(p);
    SchedP1 S{G, c, (const char*)(ws + WS_HBUF), (const char*)(ws + WS_WINT)};
    EpiP1 E{ws};
    pg8::gemm_phase<EpiP1, SchedP1>(lds, DM, S, E); }
  SEAM(1);
  if (IN(2)) { p2_conv(p);
    const float lam = ((const float*)(ws + WS_SCAL))[0];
    for (int pr = c; pr < 256; pr += G) { const int idx = pr >> 3, bh = (pr & 7) * 4 + (idx >> 3), jj = idx & 7, b = bh >> 3, h = bh & 7;
      att::attn_unit(p, (LAS char*)lds, b, h, 15 - jj, lam); att::attn_unit(p, (LAS char*)lds, b, h, jj, lam); } }
  SEAM(2);
  if (IN(3)) { SchedP3 S{G, c, (const char*)(ws + WS_O), (const char*)(ws + WS_Y), (const char*)(ws + WS_WPA), (const char*)(ws + WS_WPC)};
    EpiP3 E{(const bf16_t*)(ws + WS_SGA), (const bf16_t*)(ws + WS_SGC), (bf16_t*)(ws + WS_MERGED)};
    pg8::gemm_phase<EpiP3, SchedP3>(lds, 1024, S, E); }
  SEAM(3);
  if (IN(4)) { SchedP4 S{G, c, (const char*)(ws + WS_MERGED), (const char*)(ws + WS_WOUT)};
    EpiP4 E{p.in[I_X], (const float*)(ws + WS_STATS0), p.in[I_LN0G], p.in[I_LN0B], p.out};
    pg8::gemm_phase<EpiP4, SchedP4>(lds, DM, S, E); }
  SEAM(4);
  if (IN(5)) { p5_route(p, lds); }
  SEAM(5);
  if (IN(6)) { const MoeTab tb = moe_tables(p, lds);
    SchedMoe S{G, c, 4, DM, tb, (const char*)(ws + WS_H1), (const char*)(ws + WS_WGU), (size_t)1024 * DM * 2, (const int*)(ws + WS_LIST), true};
    EpiP6 E{(bf16_t*)(ws + WS_HB)};
    pg8::gemm_phase<EpiP6, SchedMoe>(lds, DM, S, E); }
  SEAM(6);
  if (IN(7)) { const MoeTab tb = moe_tables(p, lds);
    SchedMoe S{G, c, 8, DE, tb, (const char*)(ws + WS_HB), (const char*)(ws + WS_WD), (size_t)DM * DE * 2, (const int*)(ws + WS_LIST), false};
    EpiP7 E{(bf16_t*)(ws + WS_YK), (const int*)(ws + WS_LIST), (const bf16_t*)(ws + WS_H1), p.out};
    pg8::gemm_phase<EpiP7, SchedMoe>(lds, DE, S, E); }
  SEAM(7);
  if (IN(8)) { p8_combine(p); }
#undef IN
#undef SEAM
}

#ifndef N_LAUNCHES
#define N_LAUNCHES 9
#endif
extern "C" void kernel_launch(void* const* d_in, const int* in_sizes, int n_in, void* d_out, int out_size, void* d_ws, size_t ws_size, hipStream_t stream) {
  static int grid = 0;
  if (grid == 0) {
    if (n_in != 26 || out_size != NTOK * DM || ws_size < WS_END) { fprintf(stderr, "kernel_launch: unexpected shapes: n_in %d out %d ws %zu (need %zu)\n", n_in, out_size, ws_size, (size_t)WS_END); grid = -1; return; }
    int dev = 0, cus = 0, per_cu = 0;
    if (hipGetDevice(&dev) != hipSuccess || hipDeviceGetAttribute(&cus, hipDeviceAttributeMultiprocessorCount, dev) != hipSuccess) { grid = -1; return; }
    if (hipFuncSetAttribute((const void*)fwd, hipFuncAttributeMaxDynamicSharedMemorySize, LDS_BYTES) != hipSuccess) { fprintf(stderr, "kernel_launch: hipFuncSetAttribute failed\n"); grid = -1; return; }
    if (hipOccupancyMaxActiveBlocksPerMultiprocessor(&per_cu, (const void*)fwd, 512, LDS_BYTES) != hipSuccess || per_cu < 1) { fprintf(stderr, "kernel_launch: occupancy query says %d blocks per CU\n", per_cu); grid = -1; return; }
    grid = cus;
  }
  if (grid < 0) return;
  (void)hipMemsetAsync((char*)d_ws + WS_CTL, 0, CTL_ZERO_BYTES, stream);
  Params p{};
  for (int i = 0; i < 26; ++i) p.in[i] = (const float*)d_in[i];
  p.out = (float*)d_out; p.ws = (unsigned char*)d_ws;
  if (N_LAUNCHES == 1) { p.ph_lo = 0; p.ph_hi = 9; void* args[] = {&p};
    hipError_t e = hipLaunchCooperativeKernel((void*)fwd, dim3(grid), dim3(512), args, LDS_BYTES, stream);
    if (e != hipSuccess) fprintf(stderr, "cooperative launch failed: %s (grid %d)\n", hipGetErrorString(e), grid);
  } else {
    for (int ph = 0; ph < 9; ++ph) { p.ph_lo = ph; p.ph_hi = ph + 1; hipLaunchKernelGGL(fwd, dim3(grid), dim3(512), LDS_BYTES, stream, p); }
  }
}
```
